# Optimizing an MI355X kernel written in HIP

```python
import math
import jax, jax.numpy as jnp
from jax import lax
import numpy as np

D_MODEL = 1024
BATCH = 8
SEQ = 4096
DEPTH = 2

PLE_DIM = 256
D_FF = 2816
N_NORMS = 4
EPS = 1e-6
NEG_INF = -1e30

ATT_HEADS = 4
ATT_HEAD_DIM = 64
ATT_WIDTH = ATT_HEADS * ATT_HEAD_DIM
Q_BLOCK = 128

POOL_WINDOWS = (2, 4, 8, 16)
POOL_GROUPS = len(POOL_WINDOWS)
POOL_GROUP_DIM = 64
POOL_WIDTH = POOL_GROUPS * POOL_GROUP_DIM

SSM_GROUP_DIM = 16
SSM_GROUPS = 16
SSM_WIDTH = SSM_GROUPS * SSM_GROUP_DIM
SSM_STATE = 64
SSM_DT_MIN = 0.001
SSM_DT_MAX = 0.1

CONV_CHANNELS = 256
CONV_WIDTH = 3

N_BRANCH = 4
BRANCH_WIDTH = 256

IN_SPLITS = (ATT_WIDTH, ATT_WIDTH, ATT_WIDTH, ATT_HEADS, POOL_WIDTH, SSM_WIDTH,
             CONV_CHANNELS, CONV_CHANNELS, CONV_CHANNELS, N_BRANCH * D_MODEL)
IN_COLS = sum(IN_SPLITS)

kernel_name = 'hybrid_gated_mixer_block'


def rmsnorm(x, g):
    xf = x.astype(jnp.float32)
    y = xf * lax.rsqrt(jnp.mean(xf * xf, axis=-1, keepdims=True) + EPS)
    return (y * g.astype(jnp.float32)).astype(x.dtype)


def swiglu(x, w_gate, w_up, w_down):
    return (jax.nn.silu(x @ w_gate) * (x @ w_up)) @ w_down


def forgetting_attention(q, k, v, f_logit, f_bias):
    B, S, H, Dh = q.shape
    nb = S // Q_BLOCK
    log_f = jax.nn.log_sigmoid(f_logit.astype(jnp.float32) + f_bias.astype(jnp.float32))
    c = jnp.cumsum(log_f, axis=1)
    qf = q.astype(jnp.float32) * (Dh ** -0.5)
    kf = k.astype(jnp.float32)
    vf = v.astype(jnp.float32)
    q_blk = qf.reshape(B, nb, Q_BLOCK, H, Dh).transpose(1, 0, 3, 2, 4)
    c_blk = c.reshape(B, nb, Q_BLOCK, H).transpose(1, 0, 3, 2)
    pos_blk = jnp.arange(S, dtype=jnp.int32).reshape(nb, Q_BLOCK)
    c_k = c.transpose(0, 2, 1)
    k_pos = jnp.arange(S, dtype=jnp.int32)

    def one_block(args):
        qb, cb, pb = args
        s = jnp.einsum('bhqd,bkhd->bhqk', qb, kf)
        s = s + (cb[..., :, None] - c_k[:, :, None, :])
        mask = k_pos[None, :] <= pb[:, None]
        s = jnp.where(mask[None, None], s, NEG_INF)
        pr = jax.nn.softmax(s, axis=-1)
        return jnp.einsum('bhqk,bkhd->bqhd', pr, vf)

    out = lax.map(one_block, (q_blk, c_blk, pos_blk))
    out = out.transpose(1, 0, 2, 3, 4).reshape(B, S, H * Dh)
    return out.astype(q.dtype)


def multiscale_pool(xp, pool_w, pool_scale):
    B, S, C = xp.shape
    xf = xp.astype(jnp.float32)
    csp = jnp.concatenate([jnp.zeros((B, 1, C), jnp.float32), jnp.cumsum(xf, axis=1)], axis=1)
    win = jnp.repeat(jnp.array(POOL_WINDOWS, jnp.int32), POOL_GROUP_DIM)
    t = jnp.arange(S, dtype=jnp.int32)[:, None]
    lo = jnp.maximum(t + 1 - win[None, :], 0)
    ch = jnp.arange(C, dtype=jnp.int32)[None, :]
    window_sum = csp[:, 1:, :] - csp[:, lo, ch]
    count = jnp.minimum(t + 1, win[None, :]).astype(jnp.float32)
    pooled = window_sum / count - xf
    grp = pooled.reshape(B, S, POOL_GROUPS, POOL_GROUP_DIM)
    y = jnp.einsum('bsgc,gcd->bsgd', grp, pool_w.astype(jnp.float32)).reshape(B, S, C)
    return (y * pool_scale.astype(jnp.float32)).astype(xp.dtype)


def _ssm_combine(left, right):
    a1, b1 = left
    a2, b2 = right
    return a1 * a2, a2 * b1 + b2


def s5_ssm(u, lam_re, lam_im, log_dt, b_re, b_im, c_re, c_im, d_skip, w_glu):
    B, S, _ = u.shape
    uf = u.astype(jnp.float32).reshape(B, S, SSM_GROUPS, SSM_GROUP_DIM)
    dt = jnp.exp(log_dt.astype(jnp.float32))[:, None]
    lam = lax.complex(jnp.minimum(lam_re.astype(jnp.float32), -1e-4), lam_im.astype(jnp.float32))
    lam_bar = jnp.exp(lam * dt)
    bmat = lax.complex(b_re.astype(jnp.float32), b_im.astype(jnp.float32))
    b_bar = ((lam_bar - 1.0) / lam)[..., None] * bmat
    bu = jnp.einsum('bsgh,gph->bsgp', uf.astype(jnp.complex64), b_bar)
    a = jnp.broadcast_to(lam_bar, bu.shape)
    _, states = lax.associative_scan(_ssm_combine, (a, bu), axis=1)
    cmat = lax.complex(c_re.astype(jnp.float32), c_im.astype(jnp.float32))
    y = jnp.real(jnp.einsum('bsgp,ghp->bsgh', states, cmat))
    y = y + d_skip.astype(jnp.float32).reshape(SSM_GROUPS, SSM_GROUP_DIM) * uf
    y = y.reshape(B, S, SSM_WIDTH)
    val, gate = jnp.split(y @ w_glu.astype(jnp.float32), 2, axis=-1)
    return (val * jax.nn.sigmoid(gate)).astype(u.dtype)


def short_conv(b_gate, c_gate, xin, conv_w):
    S = xin.shape[1]
    z = c_gate * xin
    zp = jnp.pad(z, ((0, 0), (CONV_WIDTH - 1, 0), (0, 0)))
    y = conv_w[0] * zp[:, 0:S]
    for j in range(1, CONV_WIDTH):
        y = y + conv_w[j] * zp[:, j:j + S]
    return b_gate * y


def hybrid_mixer(u, w_in, f_bias, pool_w, pool_scale, lam_re, lam_im, log_dt, b_re, b_im,
                 c_re, c_im, d_skip, w_glu, conv_w, w_branch, w_out):
    B, S, _ = u.shape
    z = u @ w_in
    q, k, v, f, xp, xs, cb, cc, cx, g = jnp.split(z, np.cumsum(IN_SPLITS)[:-1].tolist(), axis=-1)
    shp = (B, S, ATT_HEADS, ATT_HEAD_DIM)
    y_att = forgetting_attention(q.reshape(shp), k.reshape(shp), v.reshape(shp), f, f_bias)
    y_pool = multiscale_pool(xp, pool_w, pool_scale)
    y_ssm = s5_ssm(xs, lam_re, lam_im, log_dt, b_re, b_im, c_re, c_im, d_skip, w_glu)
    y_conv = short_conv(cb, cc, cx, conv_w)
    ys = jnp.stack([y_att.astype(u.dtype), y_pool.astype(u.dtype),
                    y_ssm.astype(u.dtype), y_conv.astype(u.dtype)], axis=2)
    proj = jnp.einsum('bsnc,ncd->bsnd', ys, w_branch)
    gates = jax.nn.sigmoid(g.reshape(B, S, N_BRANCH, D_MODEL))
    merged = jnp.sum(gates * proj, axis=2)
    return merged @ w_out


def _normal(k, shape, std):
    return std * jax.random.normal(k, shape, jnp.float32)


def setup_inputs(seed: int = 0) -> dict:
    key = jax.random.key(seed)
    ks = jax.random.split(key, 24)
    G, P, H = SSM_GROUPS, SSM_STATE, SSM_GROUP_DIM
    x = _normal(ks[0], (BATCH, SEQ, D_MODEL), 1.0)
    p = _normal(ks[1], (DEPTH, BATCH, SEQ, PLE_DIM), 1.0)
    norm_g = 1.0 + _normal(ks[2], (DEPTH, N_NORMS, D_MODEL), 0.05)
    ffn_w_gate = _normal(ks[3], (DEPTH, 2, D_MODEL, D_FF), D_MODEL ** -0.5)
    ffn_w_up = _normal(ks[4], (DEPTH, 2, D_MODEL, D_FF), D_MODEL ** -0.5)
    ffn_w_down = _normal(ks[5], (DEPTH, 2, D_FF, D_MODEL), D_FF ** -0.5)
    w_in = _normal(ks[6], (DEPTH, D_MODEL, IN_COLS), D_MODEL ** -0.5)
    f_bias = 1.0 + 4.0 * jax.random.uniform(ks[7], (DEPTH, ATT_HEADS), jnp.float32)
    pool_w = _normal(ks[8], (DEPTH, POOL_GROUPS, POOL_GROUP_DIM, POOL_GROUP_DIM), POOL_GROUP_DIM ** -0.5)
    pool_scale = 1.0 + _normal(ks[9], (DEPTH, POOL_WIDTH), 0.1)
    ssm_lam_re = -0.5 * (1.0 + _normal(ks[10], (DEPTH, G, P), 0.01))
    ssm_lam_im = jnp.tile(math.pi * jnp.arange(P, dtype=jnp.float32), (DEPTH, G, 1))
    ssm_log_dt = math.log(SSM_DT_MIN) + jax.random.uniform(ks[11], (DEPTH, G), jnp.float32) * (
        math.log(SSM_DT_MAX) - math.log(SSM_DT_MIN))
    ssm_b_re = _normal(ks[12], (DEPTH, G, P, H), (2 * H) ** -0.5)
    ssm_b_im = _normal(ks[13], (DEPTH, G, P, H), (2 * H) ** -0.5)
    ssm_c_re = _normal(ks[14], (DEPTH, G, H, P), P ** -0.5)
    ssm_c_im = _normal(ks[15], (DEPTH, G, H, P), P ** -0.5)
    ssm_d = _normal(ks[16], (DEPTH, SSM_WIDTH), 1.0)
    ssm_w_glu = _normal(ks[17], (DEPTH, SSM_WIDTH, 2 * SSM_WIDTH), SSM_WIDTH ** -0.5)
    conv_w = _normal(ks[18], (DEPTH, CONV_WIDTH, CONV_CHANNELS), CONV_WIDTH ** -0.5)
    w_branch = _normal(ks[19], (DEPTH, N_BRANCH, BRANCH_WIDTH, D_MODEL), BRANCH_WIDTH ** -0.5)
    w_out = _normal(ks[20], (DEPTH, D_MODEL, D_MODEL), D_MODEL ** -0.5)
    ple_w_gate = _normal(ks[21], (DEPTH, D_MODEL, D_MODEL), D_MODEL ** -0.5)
    ple_w_proj = _normal(ks[22], (DEPTH, PLE_DIM, D_MODEL), PLE_DIM ** -0.5)
    final_g = 1.0 + _normal(ks[23], (D_MODEL,), 0.05)
    return {'x': x, 'p': p, 'norm_g': norm_g, 'ffn_w_gate': ffn_w_gate, 'ffn_w_up': ffn_w_up,
            'ffn_w_down': ffn_w_down, 'w_in': w_in, 'f_bias': f_bias, 'pool_w': pool_w,
            'pool_scale': pool_scale, 'ssm_lam_re': ssm_lam_re, 'ssm_lam_im': ssm_lam_im,
            'ssm_log_dt': ssm_log_dt, 'ssm_b_re': ssm_b_re, 'ssm_b_im': ssm_b_im,
            'ssm_c_re': ssm_c_re, 'ssm_c_im': ssm_c_im, 'ssm_d': ssm_d, 'ssm_w_glu': ssm_w_glu,
            'conv_w': conv_w, 'w_branch': w_branch, 'w_out': w_out, 'ple_w_gate': ple_w_gate,
            'ple_w_proj': ple_w_proj, 'final_g': final_g}


def reference(x, p, norm_g, ffn_w_gate, ffn_w_up, ffn_w_down, w_in, f_bias, pool_w, pool_scale,
              ssm_lam_re, ssm_lam_im, ssm_log_dt, ssm_b_re, ssm_b_im, ssm_c_re, ssm_c_im, ssm_d,
              ssm_w_glu, conv_w, w_branch, w_out, ple_w_gate, ple_w_proj, final_g):
    h = x
    for i in range(DEPTH):
        h = h + 0.5 * swiglu(rmsnorm(h, norm_g[i, 0]), ffn_w_gate[i, 0], ffn_w_up[i, 0], ffn_w_down[i, 0])
        h = h + hybrid_mixer(rmsnorm(h, norm_g[i, 1]), w_in[i], f_bias[i], pool_w[i], pool_scale[i],
                             ssm_lam_re[i], ssm_lam_im[i], ssm_log_dt[i], ssm_b_re[i], ssm_b_im[i],
                             ssm_c_re[i], ssm_c_im[i], ssm_d[i], ssm_w_glu[i], conv_w[i],
                             w_branch[i], w_out[i])
        h = h + 0.5 * swiglu(rmsnorm(h, norm_g[i, 2]), ffn_w_gate[i, 1], ffn_w_up[i, 1], ffn_w_down[i, 1])
        gate = jax.nn.sigmoid(rmsnorm(h, norm_g[i, 3]) @ ple_w_gate[i])
        h = h + gate * (p[i] @ ple_w_proj[i])
    return rmsnorm(h, final_g)
```

```cpp
#include <hip/hip_runtime.h>
#include <hip/hip_cooperative_groups.h>
#include <cstdio>
#include <cstdint>
namespace cg = cooperative_groups;

#ifndef MK_COOP
#define MK_COOP 0
#endif

#ifndef PHMASK
#define PHMASK 0xffff
#endif
#define EN(x) (((PHMASK) >> (x)) & 1)
#define LAS __attribute__((address_space(3)))
typedef unsigned short bf16_t;
typedef short bf16x8 __attribute__((ext_vector_type(8)));
typedef short s16x4 __attribute__((ext_vector_type(4)));
typedef float f32x4 __attribute__((ext_vector_type(4)));
typedef float f32x2 __attribute__((ext_vector_type(2)));
typedef float f32x16 __attribute__((ext_vector_type(16)));
typedef unsigned u32x4 __attribute__((ext_vector_type(4)));
typedef unsigned u32x2 __attribute__((ext_vector_type(2)));

constexpr int T = 32768, D = 1024, FF = 2816, SEQ = 4096, NBATCH = 8;
constexpr int NPH = 26;
constexpr float EPS = 1e-6f;
constexpr float LOG2E = 1.4426950408889634f;
constexpr float QSCALE = 0.125f * LOG2E;

constexpr size_t MiB = 1u << 20;
constexpr size_t WS_SS = 492 * MiB;
constexpr size_t WS_LF = 0x140000;
constexpr size_t WS_CUM = 0x1C0000;
constexpr size_t WS_WF = 0x240000;
constexpr size_t WS_PW = 0x250000;
constexpr size_t WS_BT = 0x2E0000;
constexpr size_t WS_KERN = 0x320000;
constexpr size_t WS_W = 4 * MiB;
constexpr size_t LW = 52 * MiB;
constexpr size_t W_UP0 = 0, W_DN0 = 11 * MiB, W_UP1 = 16 * MiB + MiB / 2, W_DN1 = 27 * MiB + MiB / 2, W_IN = 33 * MiB, W_V = 36 * MiB + MiB / 2,
                 W_G = 37 * MiB, W_BR = 45 * MiB, W_OUT = 47 * MiB, W_PG = 49 * MiB, W_PP = 51 * MiB, W_GLU = 51 * MiB + MiB / 2, W_POOL = 51 * MiB + 3 * MiB / 4;
constexpr size_t WS_HB = 108 * MiB;
constexpr size_t WS_A = 172 * MiB;
constexpr size_t A_Q = 0, A_K = 16 * MiB, A_XP = 32 * MiB, A_XS = 48 * MiB, A_CB = 68 * MiB, A_CC = 84 * MiB, A_CX = 100 * MiB, A_VT = 116 * MiB,
                 A_POOLED = 132 * MiB, A_E = 148 * MiB, A_YSSM = A_CB;
constexpr size_t WS_YS = 348 * MiB;
constexpr size_t WS_MG = 412 * MiB;
constexpr size_t WS_MI = 476 * MiB;
constexpr size_t WS_WE = 486 * MiB;
constexpr size_t WS_END = 512 * MiB;
constexpr int XSP = 640;

__device__ __forceinline__ int tidx() { int t = threadIdx.x; asm volatile("" : "+v"(t)); return t; }
typedef __bf16 bf16x2_t __attribute__((ext_vector_type(2)));
__device__ __forceinline__ unsigned cvt_pk_bf16(float lo, float hi) { const f32x2 v = {lo, hi}; const bf16x2_t b = __builtin_convertvector(v, bf16x2_t); return __builtin_bit_cast(unsigned, b); }
__device__ __forceinline__ float bflo(unsigned u) { return __uint_as_float(u << 16); }
__device__ __forceinline__ float bfhi(unsigned u) { return __uint_as_float(u & 0xffff0000u); }
__device__ __forceinline__ float sigm(float x) { return __builtin_amdgcn_rcpf(1.0f + __expf(-x)); }
__device__ __forceinline__ float rstd_of(const float* ss, int row) { const f32x4* p = (const f32x4*)(ss + (size_t)row * 16); const f32x4 a = p[0], b = p[1], c = p[2], d = p[3];
    const float s = (((a[0] + a[1]) + (a[2] + a[3])) + ((b[0] + b[1]) + (b[2] + b[3]))) + (((c[0] + c[1]) + (c[2] + c[3])) + ((d[0] + d[1]) + (d[2] + d[3])));
    return rsqrtf(s * (1.0f / 1024.0f) + EPS); }
__device__ __forceinline__ u32x4 pack8(f32x4 a, f32x4 b) { u32x4 w; w.x = cvt_pk_bf16(a[0], a[1]); w.y = cvt_pk_bf16(a[2], a[3]); w.z = cvt_pk_bf16(b[0], b[1]); w.w = cvt_pk_bf16(b[2], b[3]); return w; }
__device__ __forceinline__ void unpack8(u32x4 w, f32x4& a, f32x4& b) { a = (f32x4){bflo(w.x), bfhi(w.x), bflo(w.y), bfhi(w.y)}; b = (f32x4){bflo(w.z), bfhi(w.z), bflo(w.w), bfhi(w.w)}; }
__device__ __forceinline__ void st16_wt(void* p, u32x4 v) { asm volatile("global_store_dwordx4 %0, %1, off sc0 sc1" :: "v"(p), "v"(v) : "memory"); }
__device__ __forceinline__ void ld16x2_cc(const void* p, u32x4& a, u32x4& b) { asm volatile("global_load_dwordx4 %0, %2, off sc0 sc1\n\tglobal_load_dwordx4 %1, %2, off offset:256 sc0 sc1\n\ts_waitcnt vmcnt(0)" : "=&v"(a), "=&v"(b) : "v"(p) : "memory"); }
__device__ __forceinline__ float wave_sum(float v) {
#pragma unroll
    for (int o = 1; o < 64; o <<= 1) v += __shfl_xor(v, o);
    return v;
}

constexpr int BM = 256, BK = 64, HALF = 128, HTB = HALF * BK * 2, STAGE_BYTES = 8 * HTB, NXCD = 8, WGM = 8;
__device__ __forceinline__ int lds_byte(int r, int c) { const int st = (r >> 4) * 2 + (c >> 5), rr = r & 15, cc = c & 31, ob = rr * 64 + cc * 2; return st * 1024 + (ob ^ (((ob >> 9) & 1) << 5)); }
__device__ __forceinline__ void stage_rc(int b, int& R, int& C) { const int st = b / 1024, sb = b % 1024, swz = sb ^ (((sb >> 9) & 1) << 5); R = (st >> 1) * 16 + swz / 64; C = (st & 1) * 32 + (swz % 64) / 2; }
__device__ __forceinline__ int perm32(int rho) { const int n = rho >> 4, i = rho & 15; return 8 * (i >> 2) + 4 * n + (i & 3); }

struct Unit { int pm, pn, nt, kind; const char* A; const char* B; };

struct TileOrder {
    int nM, nN, nwg, G, c;
    __device__ __forceinline__ void init(int nM_, int nN_, int G_, int c_) { nM = nM_; nN = nN_; nwg = nM * nN; G = G_; c = c_; }
    __device__ __forceinline__ bool tile(int i, int& pm, int& pn) const {
        const long L = (long)i * G + c; if (L >= nwg) return false;
        int wgid = (int)L; { const int q = nwg / NXCD, r = nwg % NXCD, xcd = wgid % NXCD, off = wgid / NXCD; wgid = (xcd < r ? xcd * (q + 1) : r * (q + 1) + (xcd - r) * q) + off; }
        const int nig = WGM * nN, gid = wgid / nig, fm = gid * WGM, gsz = (nM - fm) < WGM ? (nM - fm) : WGM;
        pm = fm + ((wgid % nig) % gsz); pn = (wgid % nig) / gsz; return true;
    }
};
struct SchedPlain {
    TileOrder to; const char* A; const char* B; size_t aTile, bTile; int nt;
    __device__ __forceinline__ void init(const void* A_, int lda, const void* B_, int ldb, int nM, int nN, int nt_, int G, int c) {
        to.init(nM, nN, G, c); A = (const char*)A_; B = (const char*)B_; aTile = (size_t)BM * lda * 2; bTile = (size_t)BM * ldb * 2; nt = nt_; }
    __device__ __forceinline__ bool next(int i, Unit& u) const { int pm, pn; if (!to.tile(i, pm, pn)) return false; u.pm = pm; u.pn = pn; u.nt = nt; u.kind = 0; u.A = A + pm * aTile; u.B = B + pn * bTile; return true; }
};
struct SchedBatch {
    const char* A; const char* B; size_t aTile, bTile, aG, bG; int nMg, nNg, nt, total, G, c;
    __device__ __forceinline__ void init(const void* A_, int lda, size_t aG_, const void* B_, int ldb, size_t bG_, int nMg_, int nNg_, int nt_, int G_, int c_) {
        A = (const char*)A_; B = (const char*)B_; aTile = (size_t)BM * lda * 2; bTile = (size_t)BM * ldb * 2; aG = aG_; bG = bG_; nMg = nMg_; nNg = nNg_; nt = nt_; total = 16 * nMg * nNg; G = G_; c = c_; }
    __device__ __forceinline__ bool next(int i, Unit& u) const {
        const int L = i * G + c; if (L >= total) return false;
        const int per = nMg * nNg, g = L / per, r = L % per, pm = r / nNg, pn = r % nNg;
        u.pm = g * nMg + pm; u.pn = pn; u.nt = nt; u.kind = g; u.A = A + g * aG + pm * aTile; u.B = B + g * bG + pn * bTile; return true; }
};
struct SchedFused {
    TileOrder to; const char* HB; const char* WG; const char* YS; const char* WBR;
    __device__ __forceinline__ bool next(int i, Unit& u) const {
        int pm, pn; if (!to.tile(i >> 3, pm, pn)) return false; const int sub = i & 7, b = sub >> 1;
        u.pm = pm; u.pn = pn; u.kind = sub;
        if ((sub & 1) == 0) { u.nt = 16; u.A = HB + (size_t)pm * BM * 1024 * 2; u.B = WG + (size_t)(b * 1024 + pn * BM) * 1024 * 2; }
        else { u.nt = 4; u.A = YS + (size_t)pm * BM * 1024 * 2 + b * 512; u.B = WBR + (size_t)pn * BM * 1024 * 2 + b * 512; }
        return true; }
};

typedef f32x4 Acc[2][2][4][2];

template <int MODE  > struct EpiGLU {
    bf16_t* O; int ldc; const float* ss;
    __device__ __forceinline__ bool operator()(Acc& acc, const Unit& u, int wr, int wc, int fr, int fq) const {
        const int row0 = u.pm * BM + wr * 64 + fr, col0 = u.pn * 128 + wc * 32 + 8 * fq;
#pragma unroll
        for (int ai = 0; ai < 2; ++ai)
#pragma unroll
            for (int m = 0; m < 4; ++m) {
                const int row = row0 + ai * HALF + m * 16; const float rs = MODE == 0 ? rstd_of(ss, row) : 1.0f;
                f32x4 o[2];
#pragma unroll
                for (int n = 0; n < 2; ++n) { const f32x4 a = acc[ai][0][m][n] * rs, b = acc[ai][1][m][n] * rs;
#pragma unroll
                    for (int e = 0; e < 4; ++e) o[n][e] = MODE == 0 ? a[e] * sigm(a[e]) * b[e] : a[e] * sigm(b[e]); }
                *(u32x4*)(O + (size_t)row * ldc + col0) = pack8(o[0], o[1]);
            }
        return false;
    }
};
struct EpiRes {
    const float* hin; float* hout; bf16_t* hb; float* ssout; float coef;
    __device__ __forceinline__ bool operator()(Acc& acc, const Unit& u, int wr, int wc, int fr, int fq) const {
        const int row0 = u.pm * BM + wr * 64 + fr, col0 = u.pn * BM + wc * 32 + 8 * fq;
#pragma unroll
        for (int ai = 0; ai < 2; ++ai)
#pragma unroll
            for (int m = 0; m < 4; ++m) {
                const int row = row0 + ai * HALF + m * 16; float sq = 0.f;
#pragma unroll
                for (int bj = 0; bj < 2; ++bj) { const size_t off = (size_t)row * D + col0 + bj * HALF;
                    const f32x4 r0 = *(const f32x4*)(hin + off), r1 = *(const f32x4*)(hin + off + 4);
                    const f32x4 v0 = r0 + acc[ai][bj][m][0] * coef, v1 = r1 + acc[ai][bj][m][1] * coef;
                    *(f32x4*)(hout + off) = v0; *(f32x4*)(hout + off + 4) = v1; *(u32x4*)(hb + off) = pack8(v0, v1);
                    sq += (v0[0] * v0[0] + v0[1] * v0[1]) + (v0[2] * v0[2] + v0[3] * v0[3]) + (v1[0] * v1[0] + v1[1] * v1[1]) + (v1[2] * v1[2] + v1[3] * v1[3]); }
                sq += __shfl_xor(sq, 16); sq += __shfl_xor(sq, 32);
                if (fq == 0) ssout[(size_t)row * 16 + u.pn * 4 + wc] = sq;
                asm volatile("" ::: "memory");
            }
        return false;
    }
};
struct EpiPle {
    float* h; bf16_t* hb; const bf16_t* pp; const float* ssin; float* ssout;
    __device__ __forceinline__ bool operator()(Acc& acc, const Unit& u, int wr, int wc, int fr, int fq) const {
        const int row0 = u.pm * BM + wr * 64 + fr, col0 = u.pn * BM + wc * 32 + 8 * fq;
#pragma unroll
        for (int ai = 0; ai < 2; ++ai)
#pragma unroll
            for (int m = 0; m < 4; ++m) {
                const int row = row0 + ai * HALF + m * 16; float sq = 0.f; const float rs = rstd_of(ssin, row);
#pragma unroll
                for (int bj = 0; bj < 2; ++bj) { const size_t off = (size_t)row * D + col0 + bj * HALF;
                    const f32x4 r0 = *(const f32x4*)(h + off), r1 = *(const f32x4*)(h + off + 4);
                    f32x4 p0, p1; unpack8(*(const u32x4*)(pp + off), p0, p1);
                    f32x4 v0, v1;
#pragma unroll
                    for (int e = 0; e < 4; ++e) { v0[e] = r0[e] + sigm(acc[ai][bj][m][0][e] * rs) * p0[e]; v1[e] = r1[e] + sigm(acc[ai][bj][m][1][e] * rs) * p1[e]; }
                    *(f32x4*)(h + off) = v0; *(f32x4*)(h + off + 4) = v1; *(u32x4*)(hb + off) = pack8(v0, v1);
                    sq += (v0[0] * v0[0] + v0[1] * v0[1]) + (v0[2] * v0[2] + v0[3] * v0[3]) + (v1[0] * v1[0] + v1[1] * v1[1]) + (v1[2] * v1[2] + v1[3] * v1[3]); }
                sq += __shfl_xor(sq, 16); sq += __shfl_xor(sq, 32);
                if (fq == 0) ssout[(size_t)row * 16 + u.pn * 4 + wc] = sq;
                asm volatile("" ::: "memory");
            }
        return false;
    }
};
struct EpiZ {
    unsigned char* abase; const float* ss;
    __device__ __forceinline__ bool operator()(Acc& acc, const Unit& u, int wr, int wc, int fr, int fq) const {
        const int row0 = u.pm * BM + wr * 64 + fr; const int pn = u.pn;
        const size_t doff = pn == 0 ? A_Q : pn == 1 ? A_K : pn == 2 ? A_XP : pn == 3 ? A_XS : pn == 4 ? A_CB : pn == 5 ? A_CC : A_CX;
        bf16_t* dst = (bf16_t*)(abase + doff); const float sc = pn == 0 ? QSCALE : 1.0f;
#pragma unroll
        for (int ai = 0; ai < 2; ++ai)
#pragma unroll
            for (int m = 0; m < 4; ++m) {
                const int row = row0 + ai * HALF + m * 16; const float rs = rstd_of(ss, row) * sc;
#pragma unroll
                for (int bj = 0; bj < 2; ++bj) { const int c = bj * HALF + wc * 32 + 8 * fq;
                    const u32x4 w = pack8(acc[ai][bj][m][0] * rs, acc[ai][bj][m][1] * rs);
                    size_t e;
                    if (pn == 3) { const int g = c >> 4, h0 = c & 15; e = ((size_t)(g * 1024 + (row >> 5)) * XSP) + (row & 31) * 16 + h0; }
                    else e = (size_t)row * 256 + c;
                    *(u32x4*)(dst + e) = w; }
            }
        return false;
    }
};
struct EpiVT {
    bf16_t* VT; const float* ss;
    __device__ __forceinline__ bool operator()(Acc& acc, const Unit& u, int wr, int wc, int fr, int fq) const {
        const int row0 = u.pm * BM + wr * 64 + fr;
#pragma unroll
        for (int bj = 0; bj < 2; ++bj) { const int col = u.pn * BM + bj * HALF + wc * 32 + 8 * fq;
            f32x4 s0, s1;
#pragma unroll
            for (int e = 0; e < 4; ++e) { s0[e] = rstd_of(ss, col + e); s1[e] = rstd_of(ss, col + 4 + e); }
#pragma unroll
            for (int ai = 0; ai < 2; ++ai)
#pragma unroll
                for (int m = 0; m < 4; ++m) { const int row = row0 + ai * HALF + m * 16;
                    *(u32x4*)(VT + (size_t)row * T + col) = pack8(acc[ai][bj][m][0] * s0, acc[ai][bj][m][1] * s1); } }
        return false;
    }
};
struct EpiE {
    float* E;
    __device__ __forceinline__ bool operator()(Acc& acc, const Unit& u, int wr, int wc, int fr, int fq) const {
        const int row0 = u.pm * BM + wr * 64 + fr;
#pragma unroll
        for (int ai = 0; ai < 2; ++ai)
#pragma unroll
            for (int m = 0; m < 4; ++m) { const int row = row0 + ai * HALF + m * 16;
#pragma unroll
                for (int bj = 0; bj < 2; ++bj) { float* p = E + (size_t)row * 256 + bj * HALF + wc * 32 + 8 * fq; *(f32x4*)p = acc[ai][bj][m][0]; *(f32x4*)(p + 4) = acc[ai][bj][m][1]; } }
        return false;
    }
};
struct EpiY {
    bf16_t* Y;
    __device__ __forceinline__ bool operator()(Acc& acc, const Unit& u, int wr, int wc, int fr, int fq) const {
        const int g = u.kind, pml = u.pm & 3; const int crow0 = pml * BM + wr * 64 + fr;
#pragma unroll
        for (int ai = 0; ai < 2; ++ai)
#pragma unroll
            for (int m = 0; m < 4; ++m) { const int chunk = crow0 + ai * HALF + m * 16;
#pragma unroll
                for (int bj = 0; bj < 2; ++bj) { const int n = u.pn * BM + bj * HALF + wc * 32 + 8 * fq; const int so = n >> 4, ho = n & 15;
                    *(u32x4*)(Y + ((size_t)chunk * 32 + so) * 256 + g * 16 + ho) = pack8(acc[ai][bj][m][0], acc[ai][bj][m][1]); } }
        return false;
    }
};
struct EpiBf16 {
    bf16_t* O; int ldc;
    __device__ __forceinline__ bool operator()(Acc& acc, const Unit& u, int wr, int wc, int fr, int fq) const {
        const int row0 = u.pm * BM + wr * 64 + fr, col0 = u.pn * BM + wc * 32 + 8 * fq;
#pragma unroll
        for (int ai = 0; ai < 2; ++ai)
#pragma unroll
            for (int m = 0; m < 4; ++m) { const int row = row0 + ai * HALF + m * 16;
#pragma unroll
                for (int bj = 0; bj < 2; ++bj) *(u32x4*)(O + (size_t)row * ldc + col0 + bj * HALF) = pack8(acc[ai][bj][m][0], acc[ai][bj][m][1]); }
        return false;
    }
};
struct EpiFused {
    bf16_t* sg; float* macc; const float* ss; bf16_t* MG;
    __device__ __forceinline__ bool operator()(Acc& acc, const Unit& u, int wr, int wc, int fr, int fq) const {
        const int r0 = wr * 64 + fr, c0 = wc * 32 + 8 * fq; const int kind = u.kind;
        if ((kind & 1) == 0) {
#pragma unroll
            for (int ai = 0; ai < 2; ++ai)
#pragma unroll
                for (int m = 0; m < 4; ++m) { const int r = r0 + ai * HALF + m * 16; const float rs = rstd_of(ss, u.pm * BM + r);
#pragma unroll
                    for (int bj = 0; bj < 2; ++bj) { f32x4 a, b;
#pragma unroll
                        for (int e = 0; e < 4; ++e) { a[e] = sigm(acc[ai][bj][m][0][e] * rs); b[e] = sigm(acc[ai][bj][m][1][e] * rs); }
#ifdef DBG_GCONST
                        for (int e = 0; e < 4; ++e) { a[e] = sigm(rs * (float)(e + bj + kind)); b[e] = sigm(-rs * (float)(e + m)); }
#endif
                        *(u32x4*)(sg + r * 256 + c0 + bj * HALF) = pack8(a, b); } }
        } else {
            const int b = kind >> 1;
#pragma unroll
            for (int ai = 0; ai < 2; ++ai)
#pragma unroll
                for (int m = 0; m < 4; ++m) { const int r = r0 + ai * HALF + m * 16;
#pragma unroll
                    for (int bj = 0; bj < 2; ++bj) { const int e0 = r * 256 + c0 + bj * HALF; f32x4 g0, g1; unpack8(*(const u32x4*)(sg + e0), g0, g1);
#ifdef DBG_LOCALG
                        { const float rs = rstd_of(ss, u.pm * BM + r); for (int e = 0; e < 4; ++e) { g0[e] = sigm(rs * (float)(e + bj + kind)); g1[e] = sigm(-rs * (float)(e + m)); } }
#endif
#ifdef DBG_NOSG
                        g0 = (f32x4){1.f, 1.f, 1.f, 1.f}; g1 = g0;
#endif
                        f32x4 v0 = acc[ai][bj][m][0] * g0, v1 = acc[ai][bj][m][1] * g1;
                        if (b > 0) { v0 += *(const f32x4*)(macc + e0); v1 += *(const f32x4*)(macc + e0 + 4); }
                        if (b < 3) { *(f32x4*)(macc + e0) = v0; *(f32x4*)(macc + e0 + 4) = v1; }
                        else *(u32x4*)(MG + (size_t)(u.pm * BM + r) * D + u.pn * BM + c0 + bj * HALF) = pack8(v0, v1); }
                    asm volatile("" ::: "memory"); }
        }
        return false;
    }
};

template <class SchedT, class Epi>
__device__ __forceinline__ void gemm_phase(LAS unsigned char* lds, const int lda, const int ldb, const SchedT& S, const Epi& E) {
    const int tid = tidx();
    const int wid = __builtin_amdgcn_readfirstlane(tid >> 6), lane = tid & 63, wr = wid >> 2, wc = wid & 3, fr = lane & 15, fq = lane >> 4;
    unsigned voffA[2], voffB[2];
#pragma unroll
    for (int i = 0; i < 2; ++i) { int R, C; stage_rc(tid * 16 + i * 8192, R, C); const int Rb = (R & ~31) + perm32(R & 31);
        voffA[i] = (unsigned)(R * lda + C) * 2u; voffB[i] = (unsigned)(Rb * ldb + C) * 2u; }
    const size_t kstep = (size_t)(BK * 2);
    const size_t hstepA = (size_t)HALF * lda * 2, hstepB = (size_t)HALF * ldb * 2;
    const unsigned ldsw = (unsigned)wid * 1024u;
    const int aoff = lds_byte(wr * 64 + fr, fq * 8), boff = lds_byte(wc * 32 + fr, fq * 8);
#define PG8_SA(b, h) (((b) * 2 + (h)) * HTB)
#define PG8_SB(b, h) ((4 + (b) * 2 + (h)) * HTB)
#define PG8_STAGE(bufoff, gbase, voff) do { _Pragma("unroll") for (int _i = 0; _i < 2; ++_i) \
        __builtin_amdgcn_global_load_lds((const unsigned*)((const char*)(gbase) + (voff)[_i]), (LAS unsigned*)(lds + (bufoff) + ldsw + _i * 8192), 16, 0, 0); } while (0)
#define PG8_LDA(dst, b, h) do { _Pragma("unroll") for (int m = 0; m < 4; ++m) _Pragma("unroll") for (int k = 0; k < 2; ++k) dst[m][k] = *(const LAS bf16x8*)(lds + PG8_SA(b, h) + aoff + m * 2048 + k * 1024); } while (0)
#define PG8_LDB(dst, b, h) do { _Pragma("unroll") for (int n = 0; n < 2; ++n) _Pragma("unroll") for (int k = 0; k < 2; ++k) dst[n][k] = *(const LAS bf16x8*)(lds + PG8_SB(b, h) + boff + n * 2048 + k * 1024); } while (0)
#define PG8_MMA(ai, bj, At, Bt) do { __builtin_amdgcn_s_setprio(1); _Pragma("unroll") for (int m = 0; m < 4; ++m) _Pragma("unroll") for (int n = 0; n < 2; ++n) _Pragma("unroll") for (int k = 0; k < 2; ++k) \
        acc[ai][bj][m][n] = __builtin_amdgcn_mfma_f32_16x16x32_bf16(Bt[n][k], At[m][k], acc[ai][bj][m][n], 0, 0, 0); __builtin_amdgcn_s_setprio(0); } while (0)
#define PG8_WAIT_V(n) asm volatile("s_waitcnt vmcnt(" #n ")" ::: "memory")
#define PG8_WAIT_L(n) asm volatile("s_waitcnt lgkmcnt(" #n ")" ::: "memory")
#define PG8_BAR __builtin_amdgcn_s_barrier()
#define PG8_SCHED __builtin_amdgcn_sched_barrier(0)
#define PG8_ZERO() do { _Pragma("unroll") for (int a = 0; a < 2; ++a) _Pragma("unroll") for (int b = 0; b < 2; ++b) _Pragma("unroll") for (int m = 0; m < 4; ++m) _Pragma("unroll") for (int n = 0; n < 2; ++n) acc[a][b][m][n] = (f32x4){0.f, 0.f, 0.f, 0.f}; } while (0)
    Unit cur, nxt; int ui = 0;
    if (!S.next(0, cur)) return;
    Acc acc;
    PG8_ZERO();
    bf16x8 At[4][2], B0[2][2], B1[2][2];
    const char* cA = cur.A; const char* cB = cur.B;
    PG8_STAGE(PG8_SB(0, 0), cB, voffB); PG8_STAGE(PG8_SB(0, 1), cB + hstepB, voffB); PG8_STAGE(PG8_SA(0, 0), cA, voffA); PG8_STAGE(PG8_SA(0, 1), cA + hstepA, voffA);
    if (wr == 1) PG8_BAR;
    PG8_WAIT_V(2); PG8_BAR;
    PG8_STAGE(PG8_SB(1, 0), cB + kstep, voffB); PG8_STAGE(PG8_SA(1, 0), cA + kstep, voffA); PG8_STAGE(PG8_SB(1, 1), cB + hstepB + kstep, voffB);
    PG8_WAIT_V(6); PG8_BAR;
    for (;;) {
        const bool has_next = S.next(ui + 1, nxt);
        const char* nA = has_next ? nxt.A : cA; const char* nB = has_next ? nxt.B : cB;
        const int nt = cur.nt;
        for (int t = 0; t < nt; t += 2) {
            const bool last = (t == nt - 2);
            const char* a1 = cA + (size_t)(t + 1) * kstep;
            const char* a2 = last ? nA : cA + (size_t)(t + 2) * kstep; const char* b2 = last ? nB : cB + (size_t)(t + 2) * kstep;
            const char* a3 = a2 + kstep; const char* b3 = b2 + kstep;
            PG8_LDB(B0, 0, 0); PG8_LDB(B1, 0, 1); PG8_SCHED; PG8_LDA(At, 0, 0); PG8_STAGE(PG8_SA(1, 1), a1 + hstepA, voffA);
            PG8_WAIT_V(8); PG8_WAIT_L(0); PG8_BAR; PG8_MMA(0, 0, At, B0); PG8_MMA(0, 1, At, B1); PG8_BAR; PG8_SCHED;
            PG8_LDA(At, 0, 1); PG8_STAGE(PG8_SB(0, 0), b2, voffB); PG8_STAGE(PG8_SB(0, 1), b2 + hstepB, voffB); PG8_STAGE(PG8_SA(0, 0), a2, voffA);
            PG8_WAIT_V(8); PG8_WAIT_L(0); PG8_BAR; PG8_MMA(1, 0, At, B0); PG8_MMA(1, 1, At, B1); PG8_BAR; PG8_SCHED;
            PG8_LDB(B0, 1, 0); PG8_LDB(B1, 1, 1); PG8_SCHED; PG8_LDA(At, 1, 0); PG8_STAGE(PG8_SA(0, 1), a2 + hstepA, voffA);
            PG8_WAIT_V(8); PG8_WAIT_L(0); PG8_BAR; PG8_MMA(0, 0, At, B0); PG8_MMA(0, 1, At, B1); PG8_BAR; PG8_SCHED;
            PG8_LDA(At, 1, 1); PG8_STAGE(PG8_SB(1, 0), b3, voffB); PG8_STAGE(PG8_SB(1, 1), b3 + hstepB, voffB); PG8_STAGE(PG8_SA(1, 0), a3, voffA);
            PG8_WAIT_V(8); PG8_WAIT_L(0); PG8_BAR; PG8_MMA(1, 0, At, B0); PG8_MMA(1, 1, At, B1); PG8_BAR; PG8_SCHED;
        }
        if (wr == 0) PG8_BAR;
        int fre = fr, fqe = fq; asm volatile("" : "+v"(fre), "+v"(fqe));
        E(acc, cur, wr, wc, fre, fqe);
        if (!has_next) break;
        PG8_ZERO();
        cur = nxt; cA = nA; cB = nB; ++ui;
        if (wr == 1) PG8_BAR;
    }
    PG8_WAIT_V(0);
    PG8_BAR;
#undef PG8_SA
#undef PG8_SB
#undef PG8_STAGE
#undef PG8_LDA
#undef PG8_LDB
#undef PG8_MMA
#undef PG8_WAIT_V
#undef PG8_WAIT_L
#undef PG8_BAR
#undef PG8_SCHED
#undef PG8_ZERO
}

struct Args { const float* in[25]; float* out; unsigned char* ws; int ph_lo, ph_hi; };

__device__ __forceinline__ void tr_item(const float* W, int ldw, bf16_t* WT, int ldk, const float* ksc, LAS float* scr, int k0, int lane) {
#pragma unroll 8
    for (int i = 0; i < 32; ++i) { const int kk = 2 * i + (lane >> 5); float v = W[(size_t)(k0 + kk) * ldw + (lane & 31)]; if (ksc) v *= ksc[k0 + kk]; scr[kk * 33 + (lane & 31)] = v; }
    asm volatile("s_waitcnt lgkmcnt(0)" ::: "memory");
    const int c = lane & 7;
#pragma unroll
    for (int j = 0; j < 4; ++j) { const int n = (lane >> 3) + 8 * j; const LAS float* s = scr + (8 * c) * 33 + n;
        u32x4 o; o.x = cvt_pk_bf16(s[0 * 33], s[1 * 33]); o.y = cvt_pk_bf16(s[2 * 33], s[3 * 33]); o.z = cvt_pk_bf16(s[4 * 33], s[5 * 33]); o.w = cvt_pk_bf16(s[6 * 33], s[7 * 33]);
        *(u32x4*)(WT + (size_t)n * ldk + k0 + 8 * c) = o; }
    asm volatile("s_waitcnt lgkmcnt(0)" ::: "memory");
}
struct Seg { const float* src; int ldw, nkb, nnb; bf16_t* dst; int ldk; const float* ksc; int mflag, add; };
constexpr int NSEG = 24;
__device__ __forceinline__ void get_seg(const Args& a, int l, int s, Seg& g) {
    unsigned char* wl = a.ws + WS_W + (size_t)l * LW;
    const float* ng = a.in[2] + (size_t)l * 4 * D;
    g.ksc = nullptr; g.mflag = 0; g.add = 0; g.ldk = 1024; g.nkb = 16; g.ldw = 1024; g.nnb = 32;
    if (s < 4) {
        const int f = s >> 1, part = s & 1;
        g.src = (part ? a.in[4] : a.in[3]) + ((size_t)(l * 2 + f)) * D * FF; g.ldw = FF; g.nnb = FF / 32;
        g.dst = (bf16_t*)(wl + (f ? W_UP1 : W_UP0)); g.ksc = ng + (f ? 2 : 0) * D; g.mflag = 1; g.add = part * 128;
    } else if (s < 6) {
        const int f = s - 4; g.src = a.in[5] + ((size_t)(l * 2 + f)) * FF * D; g.ldw = D; g.nkb = FF / 64; g.nnb = 32; g.dst = (bf16_t*)(wl + (f ? W_DN1 : W_DN0)); g.ldk = FF;
    } else if (s < 15) {
        const int j = s - 6; const float* w = a.in[6] + (size_t)l * D * 6148; g.ldw = 6148; g.ksc = ng + 1 * D; g.nnb = 8;
        const int col0 = j == 0 ? 0 : j == 1 ? 256 : j == 2 ? 512 : j == 3 ? 772 : j == 4 ? 1028 : j == 5 ? 1284 : j == 6 ? 1540 : j == 7 ? 1796 : 2052;
        g.src = w + col0;
        if (j == 2) g.dst = (bf16_t*)(wl + W_V);
        else if (j == 8) { g.dst = (bf16_t*)(wl + W_G); g.nnb = 128; }
        else { const int slot = j < 2 ? j : j - 1; g.dst = (bf16_t*)(wl + W_IN) + (size_t)slot * 256 * 1024; }
    } else if (s < 19) {
        const int b = s - 15; g.src = a.in[20] + ((size_t)(l * 4 + b)) * 256 * D; g.ldw = D; g.nkb = 4; g.dst = (bf16_t*)(wl + W_BR) + b * 256;
    } else if (s == 19) { g.src = a.in[21] + (size_t)l * D * D; g.dst = (bf16_t*)(wl + W_OUT); }
    else if (s == 20) { g.src = a.in[22] + (size_t)l * D * D; g.dst = (bf16_t*)(wl + W_PG); g.ksc = ng + 3 * D; }
    else if (s == 21) { g.src = a.in[23] + (size_t)l * 256 * D; g.nkb = 4; g.dst = (bf16_t*)(wl + W_PP); g.ldk = 256; }
    else {
        const int part = s - 22; g.src = a.in[18] + (size_t)l * 256 * 512 + part * 256; g.ldw = 512; g.nkb = 4; g.nnb = 8; g.dst = (bf16_t*)(wl + W_GLU); g.ldk = 256; g.mflag = 1; g.add = part * 128;
    }
}

__device__ __forceinline__ void phase_prologue(const Args& a, LAS unsigned char* lds) {
    const int tid = tidx(), lane = tid & 63, wave = tid >> 6;
    const int gw = blockIdx.x * 8 + wave, NGW = gridDim.x * 8;
    const int gt = blockIdx.x * 512 + tid, NGT = gridDim.x * 512;
    LAS float* scr = (LAS float*)(lds + wave * 16384);
    int base = 0;
    for (int l = 0; l < 2; ++l)
        for (int s = 0; s < NSEG; ++s) {
            Seg g; get_seg(a, l, s, g);
            const int cnt = g.nkb * g.nnb;
            int first = (gw - base) % NGW; if (first < 0) first += NGW;
            for (int it = first; it < cnt; it += NGW) {
                const int kb = it / g.nnb, nb = it % g.nnb;
                const int row = 32 * nb + g.mflag * 128 * (nb >> 2) + g.add;
                tr_item(g.src + 32 * nb, g.ldw, g.dst + (size_t)row * g.ldk, g.ldk, g.ksc, scr, 64 * kb, lane);
            }
            base = (base + cnt) % NGW;
        }
    {
        float* ss = (float*)(a.ws + WS_SS); bf16_t* hb = (bf16_t*)(a.ws + WS_HB); const float* x = a.in[0];
        for (int m = gw; m < T; m += NGW) {
            const f32x4* xr = (const f32x4*)(x + (size_t)m * D) + lane; f32x4 v[4]; float s = 0.f;
#pragma unroll
            for (int j = 0; j < 4; ++j) { v[j] = xr[64 * j]; s += (v[j][0] * v[j][0] + v[j][1] * v[j][1]) + (v[j][2] * v[j][2] + v[j][3] * v[j][3]); }
            s = wave_sum(s);
            u32x2* o = (u32x2*)(hb + (size_t)m * D) + lane;
#pragma unroll
            for (int j = 0; j < 4; ++j) { u32x2 w; w.x = cvt_pk_bf16(v[j][0], v[j][1]); w.y = cvt_pk_bf16(v[j][2], v[j][3]); o[64 * j] = w; }
            if (lane < 16) ss[(size_t)m * 16 + lane] = lane == 0 ? s : 0.f;
        }
    }
    float* wf = (float*)(a.ws + WS_WF);
    for (int i = gt; i < 2 * 4 * 1024; i += NGT) { const int l = i >> 12, h = (i >> 10) & 3, k = i & 1023; wf[i] = a.in[2][(size_t)(l * 4 + 1) * D + k] * a.in[6][((size_t)l * D + k) * 6148 + 768 + h]; }
    for (int i = gt; i < 2 * 65536; i += NGT) { const int l = i >> 16, n = (i >> 8) & 255, k = i & 255; float v = 0.f;
        if ((n >> 6) == (k >> 6)) v = a.in[8][(((size_t)l * 4 + (n >> 6)) * 64 + (k & 63)) * 64 + (n & 63)] * a.in[9][l * 256 + n];
        ((bf16_t*)(a.ws + WS_W + (size_t)l * LW + W_POOL))[n * 256 + k] = (bf16_t)(cvt_pk_bf16(v, 0.f) & 0xffffu); }
    f32x2* PW = (f32x2*)(a.ws + WS_PW); f32x2* BT = (f32x2*)(a.ws + WS_BT);
    for (int i = gt; i < 2 * 16 * 33 * 64; i += NGT) { const int p = i & 63, tau = (i >> 6) % 33, lg = i / (33 * 64);
        const float dt = expf(a.in[12][lg]); const float lre = fminf(a.in[10][lg * 64 + p], -1e-4f), lim = a.in[11][lg * 64 + p];
        const float mag = expf((float)tau * lre * dt); float sn, cs; sincosf((float)tau * lim * dt, &sn, &cs);
        PW[i] = (f32x2){mag * cs, mag * sn}; }
    for (int i = gt; i < 2 * 16 * 64 * 16; i += NGT) { const int hi = i & 15, p = (i >> 4) & 63, lg = i >> 10;
        const float dt = expf(a.in[12][lg]); const float lre = fminf(a.in[10][lg * 64 + p], -1e-4f), lim = a.in[11][lg * 64 + p];
        const float mag = expf(lre * dt); float sn, cs; sincosf(lim * dt, &sn, &cs);
        const float nr = mag * cs - 1.0f, ni = mag * sn, den = 1.0f / (lre * lre + lim * lim);
        const float cr = (nr * lre + ni * lim) * den, ci = (ni * lre - nr * lim) * den;
        const float br = a.in[13][i], bi = a.in[14][i];
        BT[i] = (f32x2){cr * br - ci * bi, cr * bi + ci * br}; }
}

__device__ __forceinline__ void ssm_build1(const Args& a, int l) {
    const int gt = blockIdx.x * 512 + tidx(), NGT = gridDim.x * 512;
    const f32x2* PW = (const f32x2*)(a.ws + WS_PW) + (size_t)l * 16 * 33 * 64; const f32x2* BT = (const f32x2*)(a.ws + WS_BT) + (size_t)l * 16 * 64 * 16;
    const float* cre = a.in[15] + (size_t)l * 16 * 16 * 64; const float* cim = a.in[16] + (size_t)l * 16 * 16 * 64;
    float* kern = (float*)(a.ws + WS_KERN);
    for (int i = gt; i < 16 * 32 * 256; i += NGT) { const int hi = i & 15, ho = (i >> 4) & 15, tau = (i >> 8) & 31, g = i >> 13; float acc = 0.f;
        for (int p = 0; p < 64; ++p) { const f32x2 w = PW[(g * 33 + tau) * 64 + p], b = BT[(g * 64 + p) * 16 + hi]; const float cr = cre[(g * 16 + ho) * 64 + p], ci = cim[(g * 16 + ho) * 64 + p];
            const float xr = w.x * b.x - w.y * b.y, xi = w.x * b.y + w.y * b.x; acc += cr * xr - ci * xi; }
        if (tau == 0 && ho == hi) acc += a.in[17][l * 256 + g * 16 + ho];
        kern[i] = acc; }
    bf16_t* WE = (bf16_t*)(a.ws + WS_WE); bf16_t* MI = (bf16_t*)(a.ws + WS_MI);
    for (int i = gt; i < 16 * 256 * 64; i += NGT) { const int k8 = i & 63, n = (i >> 6) & 255, g = i >> 14; f32x4 v0 = {0, 0, 0, 0}, v1 = {0, 0, 0, 0};
        if (n < 128) { const int p = n >> 1, ri = n & 1, k = k8 * 8, sin_ = k >> 4, h0 = k & 15; const f32x2 w = PW[(g * 33 + 31 - sin_) * 64 + p];
#pragma unroll
            for (int e = 0; e < 8; ++e) { const f32x2 b = BT[(g * 64 + p) * 16 + h0 + e]; const float val = ri ? (w.x * b.y + w.y * b.x) : (w.x * b.x - w.y * b.y); if (e < 4) v0[e] = val; else v1[e - 4] = val; } }
        *(u32x4*)(WE + (size_t)(g * 256 + n) * XSP + k8 * 8) = pack8(v0, v1); }
    for (int i = gt; i < 16 * 512 * 16; i += NGT) { const int k8 = i & 15, n = (i >> 4) & 511, g = i >> 13; const int so = n >> 4, ho = n & 15; f32x4 v0, v1;
#pragma unroll
        for (int e = 0; e < 8; ++e) { const int kk = k8 * 8 + e, p = kk >> 1, ri = kk & 1; const f32x2 w = PW[(g * 33 + so + 1) * 64 + p]; const float cr = cre[(g * 16 + ho) * 64 + p], ci = cim[(g * 16 + ho) * 64 + p];
            const float val = ri ? -(cr * w.y + ci * w.x) : (cr * w.x - ci * w.y); if (e < 4) v0[e] = val; else v1[e - 4] = val; }
        *(u32x4*)(MI + (size_t)(g * 512 + n) * XSP + 512 + k8 * 8) = pack8(v0, v1); }
}
__device__ __forceinline__ void ssm_build2(const Args& a) {
    const int gt = blockIdx.x * 512 + tidx(), NGT = gridDim.x * 512;
    const float* kern = (const float*)(a.ws + WS_KERN); bf16_t* MI = (bf16_t*)(a.ws + WS_MI);
    for (int i = gt; i < 16 * 512 * 64; i += NGT) { const int k8 = i & 63, n = (i >> 6) & 511, g = i >> 15; const int so = n >> 4, ho = n & 15, k = k8 * 8, si = k >> 4, h0 = k & 15;
        f32x4 v0 = {0, 0, 0, 0}, v1 = {0, 0, 0, 0};
        if (so >= si) { const float* kp = kern + ((g * 32 + (so - si)) * 16 + ho) * 16 + h0; v0 = *(const f32x4*)kp; v1 = *(const f32x4*)(kp + 4); }
        *(u32x4*)(MI + (size_t)(g * 512 + n) * XSP + k) = pack8(v0, v1); }
}

__device__ __forceinline__ void fdot_items(const Args& a, int l, const float* ss) {
    const int lane = tidx() & 63, gw = blockIdx.x * 8 + (tidx() >> 6), NGW = gridDim.x * 8;
    const bf16_t* hb = (const bf16_t*)(a.ws + WS_HB); const float* wf = (const float*)(a.ws + WS_WF) + l * 4096; float* lf = (float*)(a.ws + WS_LF);
    for (int t = gw; t < T; t += NGW) {
        float d[4] = {0.f, 0.f, 0.f, 0.f};
#pragma unroll
        for (int j = 0; j < 2; ++j) { const int k = j * 512 + lane * 8; f32x4 x0, x1; unpack8(*(const u32x4*)(hb + (size_t)t * D + k), x0, x1);
#pragma unroll
            for (int h = 0; h < 4; ++h) { const f32x4 w0 = *(const f32x4*)(wf + h * 1024 + k), w1 = *(const f32x4*)(wf + h * 1024 + k + 4);
                d[h] += (x0[0] * w0[0] + x0[1] * w0[1]) + (x0[2] * w0[2] + x0[3] * w0[3]) + (x1[0] * w1[0] + x1[1] * w1[1]) + (x1[2] * w1[2] + x1[3] * w1[3]); } }
#pragma unroll
        for (int h = 0; h < 4; ++h) d[h] = wave_sum(d[h]);
        if (lane < 4) { const float dv = lane == 0 ? d[0] : lane == 1 ? d[1] : lane == 2 ? d[2] : d[3];
            const float xv = dv * rstd_of(ss, t) + a.in[7][l * 4 + lane];
            const float ls = xv >= 0.f ? -log1pf(expf(-xv)) : xv - log1pf(expf(xv));
            lf[(size_t)lane * T + t] = ls; }
    }
}
__device__ __forceinline__ void cumsum_items(const Args& a, LAS unsigned char* lds) {
    const int tid = tidx(), lane = tid & 63, wave = tid >> 6;
    const float* lf = (const float*)(a.ws + WS_LF); float* cum = (float*)(a.ws + WS_CUM); LAS float* wsum = (LAS float*)lds;
    for (int s = blockIdx.x; s < 32; s += gridDim.x) { const int b = s >> 2, h = s & 3; const size_t base = (size_t)h * T + (size_t)b * SEQ + tid * 8;
        f32x4 v0 = *(const f32x4*)(lf + base), v1 = *(const f32x4*)(lf + base + 4);
        v0[1] += v0[0]; v0[2] += v0[1]; v0[3] += v0[2]; v1[0] += v0[3]; v1[1] += v1[0]; v1[2] += v1[1]; v1[3] += v1[2];
        float incl = v1[3];
#pragma unroll
        for (int o = 1; o < 64; o <<= 1) { const float n = __shfl_up(incl, o); if (lane >= o) incl += n; }
        __syncthreads();
        if (lane == 63) wsum[wave] = incl;
        __syncthreads();
        float off = incl - v1[3];
        for (int w = 0; w < wave; ++w) off += wsum[w];
        v0 += off; v1 += off;
        *(f32x4*)(cum + base) = v0; *(f32x4*)(cum + base + 4) = v1;
    }
    __syncthreads();
}
__device__ __forceinline__ void poolconv_items(const Args& a, int l) {
    const int gt = blockIdx.x * 512 + tidx(), NGT = gridDim.x * 512;
    const bf16_t* XP = (const bf16_t*)(a.ws + WS_A + A_XP); bf16_t* PO = (bf16_t*)(a.ws + WS_A + A_POOLED);
    for (int i = gt; i < T * 32; i += NGT) { const int c8 = i & 31, t = i >> 5, pos = t & (SEQ - 1); const int w = 2 << (c8 >> 3); const int cnt = pos + 1 < w ? pos + 1 : w;
        f32x4 s0 = {0, 0, 0, 0}, s1 = {0, 0, 0, 0}, x0, x1; unpack8(*(const u32x4*)(XP + (size_t)t * 256 + c8 * 8), x0, x1);
        for (int j = 0; j < cnt; ++j) { f32x4 y0, y1; unpack8(*(const u32x4*)(XP + (size_t)(t - j) * 256 + c8 * 8), y0, y1); s0 += y0; s1 += y1; }
        const float inv = 1.0f / (float)cnt;
        *(u32x4*)(PO + (size_t)t * 256 + c8 * 8) = pack8(s0 * inv - x0, s1 * inv - x1); }
    const bf16_t* CB = (const bf16_t*)(a.ws + WS_A + A_CB); const bf16_t* CC = (const bf16_t*)(a.ws + WS_A + A_CC); const bf16_t* CX = (const bf16_t*)(a.ws + WS_A + A_CX);
    bf16_t* YS = (bf16_t*)(a.ws + WS_YS); const float* cw = a.in[19] + (size_t)l * 3 * 256;
    for (int i = gt; i < T * 32; i += NGT) { const int c8 = i & 31, t = i >> 5, pos = t & (SEQ - 1); const size_t e = (size_t)t * 256 + c8 * 8;
        f32x4 r0 = {0, 0, 0, 0}, r1 = {0, 0, 0, 0};
#pragma unroll
        for (int j = 0; j < 3; ++j) if (pos >= j) { f32x4 c0, c1, x0, x1; unpack8(*(const u32x4*)(CC + e - (size_t)j * 256), c0, c1); unpack8(*(const u32x4*)(CX + e - (size_t)j * 256), x0, x1);
            const f32x4 w0 = *(const f32x4*)(cw + (2 - j) * 256 + c8 * 8), w1 = *(const f32x4*)(cw + (2 - j) * 256 + c8 * 8 + 4); r0 += w0 * c0 * x0; r1 += w1 * c1 * x1; }
        f32x4 b0, b1; unpack8(*(const u32x4*)(CB + e), b0, b1);
        *(u32x4*)(YS + (size_t)t * D + 768 + c8 * 8) = pack8(b0 * r0, b1 * r1); }
}
__device__ __forceinline__ void scan_items(const Args& a, int l) {
    const int lane = tidx() & 63, wave = tidx() >> 6;
    if (wave != 0) return;
    const f32x2* PW = (const f32x2*)(a.ws + WS_PW) + (size_t)l * 16 * 33 * 64; const float* E = (const float*)(a.ws + WS_A + A_E); bf16_t* XS = (bf16_t*)(a.ws + WS_A + A_XS);
    for (int s = blockIdx.x; s < 128; s += gridDim.x) { const int b = s >> 4, g = s & 15; const f32x2 lam = PW[(g * 33 + 32) * 64 + lane]; float xr = 0.f, xi = 0.f;
        const size_t row0 = (size_t)g * 1024 + b * 128;
        for (int c0 = 0; c0 < 128; c0 += 16) { f32x2 ev[16];
#pragma unroll
            for (int j = 0; j < 16; ++j) ev[j] = *(const f32x2*)(E + (row0 + c0 + j) * 256 + 2 * lane);
#pragma unroll
            for (int j = 0; j < 16; ++j) { *(unsigned*)(XS + (row0 + c0 + j) * XSP + 512 + 2 * lane) = cvt_pk_bf16(xr, xi);
                const float nr = lam.x * xr - lam.y * xi + ev[j].x, ni = lam.x * xi + lam.y * xr + ev[j].y; xr = nr; xi = ni; } }
    }
}

__device__ __forceinline__ int crow(int r, int hi) { return (r & 3) + 8 * (r >> 2) + 4 * hi; }
__device__ __forceinline__ void attn_unit(int b, int h, int qb, const bf16_t* Q, const bf16_t* K, const bf16_t* VT, const float* cum, bf16_t* YS, LAS unsigned char* lds) {
    const int tid = tidx();
    const int lane = tid & 63, wid = __builtin_amdgcn_readfirstlane(tid >> 6), r32 = lane & 31, hi = lane >> 5;
    constexpr int KROW = 144, VROW = 136, KBUF = 64 * KROW, VBUF = 64 * VROW;
    LAS unsigned char* Kb = lds; LAS unsigned char* Vb = lds + 2 * KBUF; LAS float* Bb = (LAS float*)(lds + 2 * KBUF + 2 * VBUF);
    const int q0 = qb * 256; const size_t tok0 = (size_t)b * SEQ; const int qrel = wid * 32 + r32;
    bf16x8 qr[4];
    { const bf16_t* qp = Q + (tok0 + q0 + qrel) * 256 + h * 64 + hi * 8;
#pragma unroll
      for (int sl = 0; sl < 4; ++sl) qr[sl] = *(const bf16x8*)(qp + sl * 16); }
    const float* cumh = cum + (size_t)h * T + tok0; const float cref = cumh[q0];
    const int NT = 4 * qb + 4;
    const int sr = tid >> 3, sc = tid & 7;
    const bf16_t* ksrc = K + (tok0 + sr) * 256 + h * 64 + sc * 8;
    const bf16_t* vsrc = VT + (size_t)(h * 64 + sr) * T + tok0 + sc * 8;
    u32x4 kreg = *(const u32x4*)ksrc, vreg = *(const u32x4*)vsrc; float breg = tid < 64 ? -(cumh[tid] - cref) * LOG2E : 0.f;
    *(LAS u32x4*)(Kb + sr * KROW + sc * 16) = kreg;
    *(LAS u32x2*)(Vb + sr * VROW + sc * 16) = (u32x2){vreg.x, vreg.y}; *(LAS u32x2*)(Vb + sr * VROW + sc * 16 + 8) = (u32x2){vreg.z, vreg.w};
    if (tid < 64) Bb[tid] = breg;
    __syncthreads();
    f32x16 o0 = {}, o1 = {}; float m_run = -1e30f, l_run = 0.f;
    for (int t = 0; t < NT; ++t) {
        const int cur = t & 1;
        if (t + 1 < NT) { kreg = *(const u32x4*)(ksrc + (size_t)(t + 1) * 64 * 256); vreg = *(const u32x4*)(vsrc + (t + 1) * 64); if (tid < 64) breg = -(cumh[(t + 1) * 64 + tid] - cref) * LOG2E; }
        const int jd = t - (NT - 4);
        const bool active = (jd < 0) || (64 * jd <= wid * 32 + 31);
        if (active) {
            const LAS float* bp = Bb + cur * 64;
            f32x16 p0, p1;
#pragma unroll
            for (int g4 = 0; g4 < 4; ++g4) { const f32x4 v = *(const LAS f32x4*)(bp + 8 * g4 + 4 * hi), w = *(const LAS f32x4*)(bp + 32 + 8 * g4 + 4 * hi);
#pragma unroll
                for (int e = 0; e < 4; ++e) { p0[4 * g4 + e] = v[e]; p1[4 * g4 + e] = w[e]; } }
            const LAS unsigned char* kb = Kb + cur * KBUF + r32 * KROW + hi * 16;
#pragma unroll
            for (int sl = 0; sl < 4; ++sl) { const bf16x8 a0 = *(const LAS bf16x8*)(kb + sl * 32), a1 = *(const LAS bf16x8*)(kb + 32 * KROW + sl * 32);
                p0 = __builtin_amdgcn_mfma_f32_32x32x16_bf16(a0, qr[sl], p0, 0, 0, 0); p1 = __builtin_amdgcn_mfma_f32_32x32x16_bf16(a1, qr[sl], p1, 0, 0, 0); }
            if (jd >= 0) {
#pragma unroll
                for (int r = 0; r < 16; ++r) { const int kr = 64 * jd + crow(r, hi); if (kr > qrel) p0[r] = -1e30f; if (kr + 32 > qrel) p1[r] = -1e30f; }
            }
            float mx = fmaxf(p0[0], p1[0]);
#pragma unroll
            for (int r = 1; r < 16; ++r) mx = fmaxf(mx, fmaxf(p0[r], p1[r]));
            mx = fmaxf(mx, __shfl_xor(mx, 32));
            const float m_new = fmaxf(m_run, mx); const float alpha = __builtin_amdgcn_exp2f(m_run - m_new); m_run = m_new;
            float rs = 0.f;
#pragma unroll
            for (int r = 0; r < 16; ++r) { p0[r] = __builtin_amdgcn_exp2f(p0[r] - m_new); p1[r] = __builtin_amdgcn_exp2f(p1[r] - m_new); rs += p0[r] + p1[r]; }
            l_run = l_run * alpha + rs;
#pragma unroll
            for (int r = 0; r < 16; ++r) { o0[r] *= alpha; o1[r] *= alpha; }
            const LAS unsigned char* vb = Vb + cur * VBUF + r32 * VROW + hi * 8;
#pragma unroll
            for (int kh = 0; kh < 2; ++kh)
#pragma unroll
                for (int jj = 0; jj < 2; ++jj) {
                    u32x4 pw;
                    if (kh == 0) { pw.x = cvt_pk_bf16(p0[8 * jj + 0], p0[8 * jj + 1]); pw.y = cvt_pk_bf16(p0[8 * jj + 2], p0[8 * jj + 3]); pw.z = cvt_pk_bf16(p0[8 * jj + 4], p0[8 * jj + 5]); pw.w = cvt_pk_bf16(p0[8 * jj + 6], p0[8 * jj + 7]); }
                    else { pw.x = cvt_pk_bf16(p1[8 * jj + 0], p1[8 * jj + 1]); pw.y = cvt_pk_bf16(p1[8 * jj + 2], p1[8 * jj + 3]); pw.z = cvt_pk_bf16(p1[8 * jj + 4], p1[8 * jj + 5]); pw.w = cvt_pk_bf16(p1[8 * jj + 6], p1[8 * jj + 7]); }
                    const bf16x8 pb = __builtin_bit_cast(bf16x8, pw);
                    const int ko = (32 * kh + 16 * jj) * 2;
                    const u32x2 l0 = *(const LAS u32x2*)(vb + ko), h0 = *(const LAS u32x2*)(vb + ko + 16);
                    const u32x2 l1 = *(const LAS u32x2*)(vb + 32 * VROW + ko), h1 = *(const LAS u32x2*)(vb + 32 * VROW + ko + 16);
                    const bf16x8 va0 = __builtin_bit_cast(bf16x8, (u32x4){l0.x, l0.y, h0.x, h0.y}), va1 = __builtin_bit_cast(bf16x8, (u32x4){l1.x, l1.y, h1.x, h1.y});
                    o0 = __builtin_amdgcn_mfma_f32_32x32x16_bf16(va0, pb, o0, 0, 0, 0); o1 = __builtin_amdgcn_mfma_f32_32x32x16_bf16(va1, pb, o1, 0, 0, 0);
                }
        }
        if (t + 1 < NT) { const int nb = cur ^ 1;
            *(LAS u32x4*)(Kb + nb * KBUF + sr * KROW + sc * 16) = kreg;
            *(LAS u32x2*)(Vb + nb * VBUF + sr * VROW + sc * 16) = (u32x2){vreg.x, vreg.y}; *(LAS u32x2*)(Vb + nb * VBUF + sr * VROW + sc * 16 + 8) = (u32x2){vreg.z, vreg.w};
            if (tid < 64) Bb[nb * 64 + tid] = breg; }
        __syncthreads();
    }
    const float lt = l_run + __shfl_xor(l_run, 32); const float inv = 1.0f / lt;
    bf16_t* op = YS + (tok0 + q0 + qrel) * D + h * 64 + 4 * hi;
#pragma unroll
    for (int g4 = 0; g4 < 4; ++g4) {
        u32x2 w0, w1; w0.x = cvt_pk_bf16(o0[4 * g4] * inv, o0[4 * g4 + 1] * inv); w0.y = cvt_pk_bf16(o0[4 * g4 + 2] * inv, o0[4 * g4 + 3] * inv);
        w1.x = cvt_pk_bf16(o1[4 * g4] * inv, o1[4 * g4 + 1] * inv); w1.y = cvt_pk_bf16(o1[4 * g4 + 2] * inv, o1[4 * g4 + 3] * inv);
        *(u32x2*)(op + 8 * g4) = w0; *(u32x2*)(op + 32 + 8 * g4) = w1; }
}

__global__ void __launch_bounds__(512, 2) mk_fwd(Args a) {
    extern __shared__ __attribute__((aligned(16))) unsigned char lds_raw[];
    LAS unsigned char* lds = (LAS unsigned char*)lds_raw;
    const int G = gridDim.x, c = blockIdx.x;
    unsigned char* ws = a.ws;
    float* ssall; bf16_t* hb; unsigned char* A; bf16_t* ys; bf16_t* mg;
    for (int ph = a.ph_lo; ph < a.ph_hi; ++ph) {
        asm volatile("" : "+s"(ws));
        ssall = (float*)(ws + WS_SS); hb = (bf16_t*)(ws + WS_HB); A = ws + WS_A; ys = (bf16_t*)(ws + WS_YS); mg = (bf16_t*)(ws + WS_MG);
        if (ph >= 100) {
            const bf16_t* src = ph == 100 ? ys : mg; const int gt = c * 512 + tidx(), NGT = G * 512;
            for (int i = gt; i < T * 128; i += NGT) { f32x4 v0, v1; unpack8(*(const u32x4*)(src + (size_t)i * 8), v0, v1); *(f32x4*)(a.out + (size_t)i * 8) = v0; *(f32x4*)(a.out + (size_t)i * 8 + 4) = v1; }
        } else
        if (ph == 0) { if (EN(12)) phase_prologue(a, lds); }
        else if (ph == NPH - 1) { if (EN(13)) {
            const int lane = tidx() & 63, gw = c * 8 + (tidx() >> 6), NGW = G * 8; const float* ss = ssall;
            for (int m = gw; m < T; m += NGW) { const float rs = rstd_of(ss, m); f32x4* xr = (f32x4*)(a.out + (size_t)m * D) + lane; const f32x4* gp = (const f32x4*)a.in[24] + lane;
#pragma unroll
                for (int j = 0; j < 4; ++j) xr[64 * j] = xr[64 * j] * rs * gp[64 * j]; } }
        } else {
            const int l = (ph - 1) / 12, k = (ph - 1) % 12;
            unsigned char* wl = ws + WS_W + (size_t)l * LW;
            if ((k == 0 || k == 9) && EN(0)) {
                const int f = k == 0 ? 0 : 1;
                SchedPlain S; S.init((k == 0 && l > 0) ? mg : hb, 1024, wl + (f ? W_UP1 : W_UP0), 1024, 128, 22, 16, G, c);
                EpiGLU<0> E{(bf16_t*)A, FF, ssall + (size_t)(f ? 2 : 0) * T * 16};
                gemm_phase(lds, 1024, 1024, S, E);
                if (k == 0) ssm_build1(a, l);
                else { const int gt = c * 512 + tidx(), NGT = G * 512; const float* p = a.in[1] + (size_t)l * T * 256;
                    for (int i = gt; i < T * 32; i += NGT) { const f32x4 v0 = *(const f32x4*)(p + (size_t)i * 8), v1 = *(const f32x4*)(p + (size_t)i * 8 + 4); *(u32x4*)(mg + (size_t)i * 8) = pack8(v0, v1); } }
            } else if ((k == 1 || k == 8 || k == 10) && EN(1)) {
                const void* Aop = k == 8 ? (const void*)mg : (const void*)A; const int ld = k == 8 ? 1024 : FF;
                const void* Bop = wl + (k == 1 ? W_DN0 : k == 8 ? W_OUT : W_DN1);
                SchedPlain S; S.init(Aop, ld, Bop, ld, 128, 4, ld / 64, G, c);
                const float* hin = (l == 0 && k == 1) ? a.in[0] : a.out;
                EpiRes E{hin, a.out, hb, ssall + (size_t)(k == 1 ? 1 : k == 8 ? 2 : 3) * T * 16, k == 8 ? 1.0f : 0.5f};
                gemm_phase(lds, ld, ld, S, E);
                if (k == 1) ssm_build2(a);
                if (k == 10) { SchedPlain S2; S2.init(mg, 256, wl + W_PP, 256, 128, 4, 4, G, c); EpiBf16 E2{ys, 1024}; gemm_phase(lds, 256, 256, S2, E2); }
            } else if (k == 2 && EN(2)) {
                const float* ss = ssall + (size_t)T * 16;
                { SchedPlain S; S.init(hb, 1024, wl + W_IN, 1024, 128, 7, 16, G, c); EpiZ E{A, ss}; gemm_phase(lds, 1024, 1024, S, E); }
                { SchedPlain S; S.init(wl + W_V, 1024, hb, 1024, 1, 128, 16, G, c); EpiVT E{(bf16_t*)(A + A_VT), ss}; gemm_phase(lds, 1024, 1024, S, E); }
                fdot_items(a, l, ss);
            } else if (k == 3 && EN(3)) {
                cumsum_items(a, lds);
                { SchedBatch S; S.init(A + A_XS, XSP, (size_t)1024 * XSP * 2, ws + WS_WE, XSP, (size_t)256 * XSP * 2, 4, 1, 8, G, c); EpiE E{(float*)(A + A_E)}; gemm_phase(lds, XSP, XSP, S, E); }
                poolconv_items(a, l);
            } else if (k == 4 && EN(4)) {
                scan_items(a, l);
                __syncthreads();
                for (int pr = c; pr < 256; pr += G) { const int bh = pr >> 3, s = pr & 7;
                    attn_unit(bh >> 2, bh & 3, 15 - s, (const bf16_t*)(A + A_Q), (const bf16_t*)(A + A_K), (const bf16_t*)(A + A_VT), (const float*)(ws + WS_CUM), ys, lds);
                    attn_unit(bh >> 2, bh & 3, s, (const bf16_t*)(A + A_Q), (const bf16_t*)(A + A_K), (const bf16_t*)(A + A_VT), (const float*)(ws + WS_CUM), ys, lds); }
                { SchedPlain S; S.init(A + A_POOLED, 256, wl + W_POOL, 256, 128, 1, 4, G, c); EpiBf16 E{ys + 256, 1024}; gemm_phase(lds, 256, 256, S, E); }
            } else if (k == 5 && EN(5)) {
                SchedBatch S; S.init(A + A_XS, XSP, (size_t)1024 * XSP * 2, ws + WS_MI, XSP, (size_t)512 * XSP * 2, 4, 2, 10, G, c); EpiY E{(bf16_t*)(A + A_YSSM)}; gemm_phase(lds, XSP, XSP, S, E);
            } else if (k == 6 && EN(6)) {
                SchedPlain S; S.init(A + A_YSSM, 256, wl + W_GLU, 256, 128, 2, 4, G, c); EpiGLU<1> E{ys + 512, 1024, nullptr}; gemm_phase(lds, 256, 256, S, E);
            } else if (k == 7 && EN(7)) {
                SchedFused S; S.to.init(128, 4, G, c); S.HB = (const char*)hb; S.WG = (const char*)(wl + W_G); S.YS = (const char*)ys; S.WBR = (const char*)(wl + W_BR);
                EpiFused E{(bf16_t*)A + (size_t)c * 65536, (float*)(A + 32 * MiB) + (size_t)c * 65536, ssall + (size_t)T * 16, mg};
                gemm_phase(lds, 1024, 1024, S, E);
            } else if (k == 11 && EN(11)) {
                SchedPlain S; S.init(hb, 1024, wl + W_PG, 1024, 128, 4, 16, G, c);
                EpiPle E{a.out, mg, ys, ssall + (size_t)3 * T * 16, ssall};
                gemm_phase(lds, 1024, 1024, S, E);
            }
        }
        if (ph + 1 < a.ph_hi) cg::this_grid().sync();
    }
}

constexpr int LDS_BYTES = STAGE_BYTES + 1024;

extern "C" void kernel_launch(void* const* d_in, const int* in_sizes, int n_in, void* d_out, int out_size, void* d_ws, size_t ws_size, hipStream_t stream) {
    static int grid = 0;
    if (grid == 0) {
        if (n_in != 25 || out_size != T * D || ws_size < WS_END) { fprintf(stderr, "kernel_launch: unexpected shapes (n_in %d out %d ws %zu)\n", n_in, out_size, ws_size); grid = -1; return; }
        int dev = 0, cus = 0, per_cu = 0;
        hipGetDevice(&dev); hipDeviceGetAttribute(&cus, hipDeviceAttributeMultiprocessorCount, dev);
        hipFuncSetAttribute((const void*)mk_fwd, hipFuncAttributeMaxDynamicSharedMemorySize, LDS_BYTES);
        if (hipOccupancyMaxActiveBlocksPerMultiprocessor(&per_cu, (const void*)mk_fwd, 512, LDS_BYTES) != hipSuccess || per_cu < 1) per_cu = 1;
        (void)hipGetLastError();
        grid = cus * 1;
        if (grid <= 0) grid = 256;
    }
    if (grid < 0) return;
    Args a{};
    for (int i = 0; i < 25; ++i) a.in[i] = (const float*)d_in[i];
    a.out = (float*)d_out; a.ws = (unsigned char*)d_ws;
#if MK_COOP
    a.ph_lo = 0; a.ph_hi = NPH;
    void* args[] = {&a};
    hipError_t e = hipLaunchCooperativeKernel((const void*)mk_fwd, dim3(grid), dim3(512), args, LDS_BYTES, stream);
    if (e != hipSuccess) fprintf(stderr, "cooperative launch failed: %s (grid %d)\n", hipGetErrorString(e), grid);
#else
#ifndef DBG_STOP
#define DBG_STOP NPH
#endif
    for (int ph = 0; ph < DBG_STOP; ++ph) { a.ph_lo = ph; a.ph_hi = ph + 1; hipLaunchKernelGGL(mk_fwd, dim3(grid), dim3(512), LDS_BYTES, stream, a); }
#ifdef DBG_DUMP
    a.ph_lo = DBG_DUMP; a.ph_hi = DBG_DUMP + 1; hipLaunchKernelGGL(mk_fwd, dim3(grid), dim3(512), LDS_BYTES, stream, a);
#endif
#endif
}
```
